# Optimizing an MI355X kernel written in HIP

```python
import jax, jax.numpy as jnp
from jax import lax
import numpy as np

D_MODEL = 1024
BATCH = 8
SEQ = 4096
DEPTH = 2

GRID_W = 64
CTX_LEN = 256
HEAD_DIM = 64
N_Q_HEADS = 8
N_KV_HEADS = 2
Q_GROUP = N_Q_HEADS // N_KV_HEADS
ATTN_WIDTH = N_Q_HEADS * HEAD_DIM
KV_WIDTH = N_KV_HEADS * HEAD_DIM
CHUNK = 128
N_SG_GROUPS = 4
SG_WIDTH = D_MODEL - ATTN_WIDTH
SG_GROUP_DIM = SG_WIDTH // N_SG_GROUPS
IN_WIDTH = ATTN_WIDTH + 2 * KV_WIDTH + 2 * SG_WIDTH
Q_BLOCK = 128
ROPE_THETA = 10000.0
AXIS_ROPE_DIM = HEAD_DIM // 2
CONV_WIDTH = 31
D_FF = ((8 * D_MODEL // 3 + 255) // 256) * 256
N_EVEN = (DEPTH + 1) // 2
N_ODD = DEPTH // 2
EPS = 1e-6

kernel_name = "hybrid_attn_sgmlp_conformer_dit"


def rms_norm(x, g):
    xf = x.astype(jnp.float32)
    y = xf * lax.rsqrt(jnp.mean(xf * xf, axis=-1, keepdims=True) + EPS)
    return (y * g.astype(jnp.float32)).astype(x.dtype)


def layer_norm(x, g=None, b=None):
    xf = x.astype(jnp.float32)
    mu = jnp.mean(xf, axis=-1, keepdims=True)
    var = jnp.mean(jnp.square(xf - mu), axis=-1, keepdims=True)
    y = (xf - mu) * lax.rsqrt(var + EPS)
    if g is not None:
        y = y * g.astype(jnp.float32) + b.astype(jnp.float32)
    return y.astype(x.dtype)


def axial_rope_tables(n):
    rows = n // GRID_W
    row = jnp.broadcast_to(jnp.arange(rows)[:, None], (rows, GRID_W)).reshape(-1).astype(jnp.float32)
    col = jnp.broadcast_to(jnp.arange(GRID_W)[None, :], (rows, GRID_W)).reshape(-1).astype(jnp.float32)
    inv = ROPE_THETA ** (-jnp.arange(0, AXIS_ROPE_DIM, 2, dtype=jnp.float32) / AXIS_ROPE_DIM)
    ang_r = row[:, None] * inv[None, :]
    ang_c = col[:, None] * inv[None, :]
    return (jnp.cos(ang_r), jnp.sin(ang_r), jnp.cos(ang_c), jnp.sin(ang_c))


def rotate_half(x, cos, sin):
    x1, x2 = jnp.split(x, 2, axis=-1)
    cos = cos[None, :, None, :]
    sin = sin[None, :, None, :]
    return jnp.concatenate([x1 * cos - x2 * sin, x2 * cos + x1 * sin], axis=-1)


def apply_axial_rope(x, tables):
    cos_r, sin_r, cos_c, sin_c = tables
    xf = x.astype(jnp.float32)
    xr, xc = jnp.split(xf, 2, axis=-1)
    out = jnp.concatenate([rotate_half(xr, cos_r, sin_r), rotate_half(xc, cos_c, sin_c)], axis=-1)
    return out.astype(x.dtype)


def block_attention(q, k, v):
    b, n = q.shape[0], q.shape[1]
    nb = n // Q_BLOCK
    qb = (q * HEAD_DIM ** -0.5).reshape(b, nb, Q_BLOCK, N_KV_HEADS, Q_GROUP, HEAD_DIM)
    qb = qb.transpose(1, 0, 2, 3, 4, 5)

    def one_block(q_blk):
        s = jnp.einsum('bqkgd,bskd->bkgqs', q_blk, k).astype(jnp.float32)
        p = jax.nn.softmax(s, axis=-1).astype(v.dtype)
        return jnp.einsum('bkgqs,bskd->bqkgd', p, v)

    o = lax.map(one_block, qb)
    return o.transpose(1, 0, 2, 3, 4, 5).reshape(b, n, ATTN_WIDTH)


def spatial_gating(u, v, w_sp, b_sp):
    b, n = u.shape[0], u.shape[1]
    shape = (b, n // CHUNK, CHUNK, N_SG_GROUPS, SG_GROUP_DIM)
    vn = layer_norm(v.reshape(shape))
    mixed = jnp.einsum('gpq,bmqgc->bmpgc', w_sp, vn) + b_sp.T[:, :, None]
    return (u.reshape(shape) * mixed).reshape(b, n, SG_WIDTH)


def split_in_proj(p):
    o1 = ATTN_WIDTH
    o2 = o1 + KV_WIDTH
    o3 = o2 + KV_WIDTH
    o4 = o3 + SG_WIDTH
    return jnp.split(p, [o1, o2, o3, o4], axis=-1)


def even_mixer(xm, xc, w_in, q_gain, k_gain, w_sp, b_sp, w_out, rope, ctx_out):
    b, n, _ = xm.shape
    bc, m, _ = xc.shape
    q, k, v, su, sv = split_in_proj(xm @ w_in)
    q = apply_axial_rope(rms_norm(q.reshape(b, n, N_Q_HEADS, HEAD_DIM), q_gain), rope)
    k = apply_axial_rope(rms_norm(k.reshape(b, n, N_KV_HEADS, HEAD_DIM), k_gain), rope)
    v = v.reshape(b, n, N_KV_HEADS, HEAD_DIM)
    if ctx_out:
        qc, kc, vc, suc, svc = split_in_proj(xc @ w_in)
    else:
        kc, vc = jnp.split(xc @ w_in[:, ATTN_WIDTH:ATTN_WIDTH + 2 * KV_WIDTH], 2, axis=-1)
    kc = rms_norm(kc.reshape(bc, m, N_KV_HEADS, HEAD_DIM), k_gain)
    vc = vc.reshape(bc, m, N_KV_HEADS, HEAD_DIM)
    attn = block_attention(q, jnp.concatenate([kc, k], axis=1), jnp.concatenate([vc, v], axis=1))
    sg = spatial_gating(jax.nn.gelu(su), jax.nn.gelu(sv), w_sp, b_sp)
    y = jnp.concatenate([attn, sg], axis=-1) @ w_out
    yc = None
    if ctx_out:
        qc = rms_norm(qc.reshape(bc, m, N_Q_HEADS, HEAD_DIM), q_gain)
        attn_c = block_attention(qc, kc, vc)
        sg_c = spatial_gating(jax.nn.gelu(suc), jax.nn.gelu(svc), w_sp, b_sp)
        yc = jnp.concatenate([attn_c, sg_c], axis=-1) @ w_out
    return y, yc


def conformer_conv(x, w_pw1, b_pw1, w_dw, b_dw, ln_g, ln_b, w_pw2, b_pw2):
    a, gate = jnp.split(x @ w_pw1 + b_pw1, 2, axis=-1)
    h = a * jax.nn.sigmoid(gate)
    h = lax.conv_general_dilated(h, w_dw[:, None, :].astype(h.dtype), window_strides=(1,),
                                 padding=[(CONV_WIDTH // 2, CONV_WIDTH // 2)],
                                 dimension_numbers=('NWC', 'WIO', 'NWC'),
                                 feature_group_count=D_MODEL) + b_dw
    h = jax.nn.silu(layer_norm(h, ln_g, ln_b))
    return h @ w_pw2 + b_pw2


def swiglu_ffn(x, w_in, w_out):
    g, u = jnp.split(x @ w_in, 2, axis=-1)
    return (jax.nn.silu(g) * u) @ w_out


def adaln(cvec, w_mod, b_mod):
    return jnp.split(jax.nn.silu(cvec) @ w_mod + b_mod, 6, axis=-1)


def setup_inputs(seed: int = 0) -> dict:
    key = jax.random.key(seed)
    ks = iter(jax.random.split(key, 32))
    f32 = jnp.float32

    def nrm(shape, scale):
        return jax.random.normal(next(ks), shape, f32) * scale

    D = D_MODEL
    return {
        'x': nrm((BATCH, SEQ, D), 1.0),
        'c': nrm((BATCH, D), 1.0),
        'ctx': nrm((BATCH, CTX_LEN, D), 1.0),
        'c_ctx': nrm((D,), 1.0),
        'w_mod': nrm((DEPTH, D, 6 * D), 0.5 * D ** -0.5),
        'b_mod': nrm((DEPTH, 6 * D), 0.01),
        'g_mix': 1.0 + nrm((DEPTH, D), 0.01),
        'g_ffn': 1.0 + nrm((DEPTH, D), 0.01),
        'w_ffn_in': nrm((DEPTH, D, 2 * D_FF), D ** -0.5),
        'w_ffn_out': nrm((DEPTH, D_FF, D), D_FF ** -0.5),
        'w_in': nrm((N_EVEN, D, IN_WIDTH), D ** -0.5),
        'q_gain': 1.0 + nrm((N_EVEN, HEAD_DIM), 0.01),
        'k_gain': 1.0 + nrm((N_EVEN, HEAD_DIM), 0.01),
        'w_sp': nrm((N_EVEN, N_SG_GROUPS, CHUNK, CHUNK), CHUNK ** -0.5),
        'b_sp': 1.0 + nrm((N_EVEN, N_SG_GROUPS, CHUNK), 0.01),
        'w_out': nrm((N_EVEN, ATTN_WIDTH + SG_WIDTH, D), (ATTN_WIDTH + SG_WIDTH) ** -0.5),
        'w_pw1': nrm((N_ODD, D, 2 * D), D ** -0.5),
        'b_pw1': nrm((N_ODD, 2 * D), 0.01),
        'w_dw': nrm((N_ODD, CONV_WIDTH, D), CONV_WIDTH ** -0.5),
        'b_dw': nrm((N_ODD, D), 0.01),
        'ln_g': 1.0 + nrm((N_ODD, D), 0.01),
        'ln_b': nrm((N_ODD, D), 0.01),
        'w_pw2': nrm((N_ODD, D, D), D ** -0.5),
        'b_pw2': nrm((N_ODD, D), 0.01),
        'g_final': 1.0 + nrm((D,), 0.01),
    }


def reference(x, c, ctx, c_ctx, w_mod, b_mod, g_mix, g_ffn, w_ffn_in, w_ffn_out,
              w_in, q_gain, k_gain, w_sp, b_sp, w_out,
              w_pw1, b_pw1, w_dw, b_dw, ln_g, ln_b, w_pw2, b_pw2, g_final):
    n = x.shape[1]
    rope = axial_rope_tables(n)
    h, hc = x, ctx
    for l in range(DEPTH):
        even = (l % 2 == 0)
        i = l // 2
        ctx_after = any(j % 2 == 0 for j in range(l + 1, DEPTH))
        sh1, sc1, gt1, sh2, sc2, gt2 = [t[:, None, :] for t in adaln(c, w_mod[l], b_mod[l])]
        xm = rms_norm(h, g_mix[l]) * (1.0 + sc1) + sh1
        if even or ctx_after:
            csh1, csc1, cgt1, csh2, csc2, cgt2 = adaln(c_ctx, w_mod[l], b_mod[l])
            xc = rms_norm(hc, g_mix[l]) * (1.0 + csc1) + csh1
        if even:
            y, yc = even_mixer(xm, xc, w_in[i], q_gain[i], k_gain[i], w_sp[i], b_sp[i], w_out[i],
                               rope, ctx_after)
        else:
            conv_p = (w_pw1[i], b_pw1[i], w_dw[i], b_dw[i], ln_g[i], ln_b[i], w_pw2[i], b_pw2[i])
            y = conformer_conv(xm, *conv_p)
            yc = conformer_conv(xc, *conv_p) if ctx_after else None
        h = h + gt1 * y
        h = h + gt2 * swiglu_ffn(rms_norm(h, g_ffn[l]) * (1.0 + sc2) + sh2, w_ffn_in[l], w_ffn_out[l])
        if ctx_after:
            hc = hc + cgt1 * yc
            hc = hc + cgt2 * swiglu_ffn(rms_norm(hc, g_ffn[l]) * (1.0 + csc2) + csh2,
                                        w_ffn_in[l], w_ffn_out[l])
    return rms_norm(h, g_final)
```

```cpp
#include <hip/hip_runtime.h>
#include <hip/hip_bf16.h>
#include <cstdio>
#include <cstdint>
#include <cmath>
namespace pg8 {
#define PG8_LAS __attribute__((address_space(3)))
typedef unsigned short bf16_t;
typedef short bf16x8 __attribute__((ext_vector_type(8)));
typedef float f32x4 __attribute__((ext_vector_type(4)));
typedef unsigned u32x4 __attribute__((ext_vector_type(4)));
constexpr int BM = 256, BK = 64, HALF = 128, HTB = HALF * BK * 2  , STAGE_BYTES = 8 * HTB, NXCD = 8, WGM = 8;

__host__ __device__ __forceinline__ int lds_byte(int r, int c) { const int st = (r >> 4) * 2 + (c >> 5), rr = r & 15, cc = c & 31, ob = rr * 64 + cc * 2; return st * 1024 + (ob ^ (((ob >> 9) & 1) << 5)); }
__host__ __device__ __forceinline__ void stage_rc(int b, int& R, int& C) { const int st = b / 1024, sb = b % 1024, swz = sb ^ (((sb >> 9) & 1) << 5); R = (st >> 1) * 16 + swz / 64; C = (st & 1) * 32 + (swz % 64) / 2; }
__host__ __device__ __forceinline__ int perm32(int rho) { const int n = rho >> 4, i = rho & 15; return 8 * (i >> 2) + 4 * n + (i & 3); }

struct Unit { int pm, pn; };
struct Gemm { const bf16_t* A; const bf16_t* Bt; int M, N, K; };

struct StaticOrder {
    int nM, nN, nwg, G, c;
    __host__ __device__ void init(int M, int N, int G_, int c_) { nM = M / BM; nN = N / BM; nwg = nM * nN; G = G_; c = c_; }
    __host__ __device__ bool next(int i, Unit& u) const {
        const long L = (long)i * G + c; if (L >= nwg) return false;
        int wgid = (int)L; { const int q = nwg / NXCD, r = nwg % NXCD, xcd = wgid % NXCD, off = wgid / NXCD; wgid = (xcd < r ? xcd * (q + 1) : r * (q + 1) + (xcd - r) * q) + off; }
        const int nig = WGM * nN, gid = wgid / nig, fm = gid * WGM, gsz = (nM - fm) < WGM ? (nM - fm) : WGM;
        u.pm = fm + ((wgid % nig) % gsz); u.pn = (wgid % nig) / gsz; return true;
    }
    __device__ __forceinline__ void a_ready(const Unit&) const {}
    __device__ __forceinline__ void done(const Unit&) const {}
};

__device__ __forceinline__ unsigned cvt_pk_bf16(float lo, float hi) { unsigned r; asm volatile("v_cvt_pk_bf16_f32 %0, %1, %2" : "=v"(r) : "v"(lo), "v"(hi)); return r; }
__device__ __forceinline__ float sigmoidf_fast(float x) { return __builtin_amdgcn_rcpf(1.0f + __builtin_amdgcn_exp2f(-1.4426950408889634f * x)); }

struct EpiStoreBf16 {
    static constexpr bool PERM = true, AFTER_DRAIN = false;
    bf16_t* O; int ldc;
    __device__ __forceinline__ void operator()(const f32x4 (&acc)[2][2][4][2], const Unit& u, int wr, int wc, int fr, int fq) const {
        const int row0 = u.pm * BM + wr * 64 + fr, col0 = u.pn * BM + wc * 32 + 8 * fq;
#pragma unroll
        for (int ai = 0; ai < 2; ++ai)
#pragma unroll
            for (int m = 0; m < 4; ++m) { bf16_t* rowp = O + (size_t)(row0 + ai * HALF + m * 16) * ldc + col0;
#pragma unroll
                for (int bj = 0; bj < 2; ++bj) { const f32x4 v0 = acc[ai][bj][m][0], v1 = acc[ai][bj][m][1];
                    u32x4 w; w.x = cvt_pk_bf16(v0[0], v0[1]); w.y = cvt_pk_bf16(v0[2], v0[3]); w.z = cvt_pk_bf16(v1[0], v1[1]); w.w = cvt_pk_bf16(v1[2], v1[3]);
                    *(u32x4*)(rowp + bj * HALF) = w; } }
    }
};
struct EpiSwiGLU {
    static constexpr bool PERM = true, AFTER_DRAIN = false;
    bf16_t* O; int ldc;
    __device__ __forceinline__ void operator()(const f32x4 (&acc)[2][2][4][2], const Unit& u, int wr, int wc, int fr, int fq) const {
        const int row0 = u.pm * BM + wr * 64 + fr, col0 = u.pn * HALF + wc * 32 + 8 * fq;
#pragma unroll
        for (int ai = 0; ai < 2; ++ai)
#pragma unroll
            for (int m = 0; m < 4; ++m) { bf16_t* rowp = O + (size_t)(row0 + ai * HALF + m * 16) * ldc + col0;
                float r[8];
#pragma unroll
                for (int n = 0; n < 2; ++n)
#pragma unroll
                    for (int i = 0; i < 4; ++i) { const float g = acc[ai][0][m][n][i], up = acc[ai][1][m][n][i]; r[4 * n + i] = g * sigmoidf_fast(g) * up; }
                u32x4 w; w.x = cvt_pk_bf16(r[0], r[1]); w.y = cvt_pk_bf16(r[2], r[3]); w.z = cvt_pk_bf16(r[4], r[5]); w.w = cvt_pk_bf16(r[6], r[7]);
                *(u32x4*)rowp = w; }
    }
};
struct EpiGLU {
    static constexpr bool PERM = true, AFTER_DRAIN = false;
    bf16_t* O; int ldc; const float* bias;
    __device__ __forceinline__ void operator()(const f32x4 (&acc)[2][2][4][2], const Unit& u, int wr, int wc, int fr, int fq) const {
        const int row0 = u.pm * BM + wr * 64 + fr, col0 = u.pn * HALF + wc * 32 + 8 * fq;
        f32x4 ba[2], bg[2];
#pragma unroll
        for (int n = 0; n < 2; ++n) { ba[n] = *(const f32x4*)(bias + col0 + 4 * n); bg[n] = *(const f32x4*)(bias + 1024 + col0 + 4 * n); }
#pragma unroll
        for (int ai = 0; ai < 2; ++ai)
#pragma unroll
            for (int m = 0; m < 4; ++m) { bf16_t* rowp = O + (size_t)(row0 + ai * HALF + m * 16) * ldc + col0;
                float r[8];
#pragma unroll
                for (int n = 0; n < 2; ++n)
#pragma unroll
                    for (int i = 0; i < 4; ++i) { const float a = acc[ai][0][m][n][i] + ba[n][i], gt = acc[ai][1][m][n][i] + bg[n][i]; r[4 * n + i] = a * sigmoidf_fast(gt); }
                u32x4 w; w.x = cvt_pk_bf16(r[0], r[1]); w.y = cvt_pk_bf16(r[2], r[3]); w.z = cvt_pk_bf16(r[4], r[5]); w.w = cvt_pk_bf16(r[6], r[7]);
                *(u32x4*)rowp = w; }
    }
};
struct EpiRes {
    static constexpr bool PERM = false, AFTER_DRAIN = false;
    const float* base; float* out; int ldc; const float* gate; int gstride; const float* bias; int rpb_shift;
    __device__ __forceinline__ void operator()(const f32x4 (&acc)[2][2][4][2], const Unit& u, int wr, int wc, int fr, int fq) const {
        const int row0 = u.pm * BM + wr * 64 + fr, col0 = u.pn * BM + wc * 32 + 4 * fq; const int b = (u.pm * BM) >> rpb_shift;
        f32x4 gv[2][2], bv[2][2];
#pragma unroll
        for (int bj = 0; bj < 2; ++bj)
#pragma unroll
            for (int n = 0; n < 2; ++n) { gv[bj][n] = *(const f32x4*)(gate + (size_t)b * gstride + col0 + bj * HALF + n * 16);
                bv[bj][n] = bias ? *(const f32x4*)(bias + col0 + bj * HALF + n * 16) : (f32x4){0.f, 0.f, 0.f, 0.f}; }
#pragma unroll
        for (int ai = 0; ai < 2; ++ai)
#pragma unroll
            for (int m = 0; m < 4; ++m) { const size_t off = (size_t)(row0 + ai * HALF + m * 16) * ldc + col0;
#pragma unroll
                for (int bj = 0; bj < 2; ++bj)
#pragma unroll
                    for (int n = 0; n < 2; ++n) { const f32x4 bs = *(const f32x4*)(base + off + bj * HALF + n * 16);
                        *(f32x4*)(out + off + bj * HALF + n * 16) = bs + gv[bj][n] * (acc[ai][bj][m][n] + bv[bj][n]); } }
    }
};
struct ExtraOrder {
    StaticOrder s; int extra, extra_pn;
    __device__ __forceinline__ bool next(int i, Unit& u) const {
        const long L = (long)i * s.G + s.c; if (L < s.nwg) return s.next(i, u);
        const long e = L - s.nwg; if (e >= extra) return false; u.pm = s.nM + (int)e; u.pn = extra_pn; return true;
    }
    __device__ __forceinline__ void a_ready(const Unit&) const {}
    __device__ __forceinline__ void done(const Unit&) const {}
};
template <class Epi, class Sched, bool ALIGN_EPI = false, bool SP2 = false>
__device__ __forceinline__ void gemm_phase(PG8_LAS unsigned char* lds, const Gemm g, const Sched& S, const Epi& E) {
    int tid_ = threadIdx.x; asm volatile("" : "+v"(tid_));
    const int tid = tid_, wid = __builtin_amdgcn_readfirstlane(tid >> 6), lane = tid & 63, wr = wid >> 2, wc = wid & 3, fr = lane & 15, fq = lane >> 4;
    const int K = g.K, nt = K / BK;
    unsigned voffA[2], voffB[2];
#pragma unroll
    for (int i = 0; i < 2; ++i) { int R, C; stage_rc(tid * 16 + i * 8192, R, C); const int Rb = Epi::PERM ? ((R & ~31) + perm32(R & 31)) : R;
        voffA[i] = (unsigned)(R * K + C) * 2u; voffB[i] = (unsigned)(Rb * K + C) * 2u; }
    const size_t kstep = (size_t)(BK * 2);
    const size_t hstep = (size_t)HALF * K * 2;
    const size_t tstep = 2 * hstep;
    const unsigned ldsw = (unsigned)wid * 1024u;
    const int aoff = lds_byte(wr * 64 + fr, fq * 8), boff = lds_byte(wc * 32 + fr, fq * 8);
#define PG8_SA(b, h) (((b) * 2 + (h)) * HTB)
#define PG8_SB(b, h) ((4 + (b) * 2 + (h)) * HTB)
#define PG8_STAGE(bufoff, gbase, voff) do { _Pragma("unroll") for (int _i = 0; _i < 2; ++_i) \
        __builtin_amdgcn_global_load_lds((const unsigned*)((const char*)(gbase) + (voff)[_i]), (PG8_LAS unsigned*)(lds + (bufoff) + ldsw + _i * 8192), 16, 0, 0); } while (0)
#define PG8_LDA(dst, b, h) do { _Pragma("unroll") for (int m = 0; m < 4; ++m) _Pragma("unroll") for (int k = 0; k < 2; ++k) dst[m][k] = *(const PG8_LAS bf16x8*)(lds + PG8_SA(b, h) + aoff + m * 2048 + k * 1024); } while (0)
#define PG8_LDB(dst, b, h) do { _Pragma("unroll") for (int n = 0; n < 2; ++n) _Pragma("unroll") for (int k = 0; k < 2; ++k) dst[n][k] = *(const PG8_LAS bf16x8*)(lds + PG8_SB(b, h) + boff + n * 2048 + k * 1024); } while (0)
#define PG8_MMA(ai, bj, At, Bt) do { __builtin_amdgcn_s_setprio(1); _Pragma("unroll") for (int m = 0; m < 4; ++m) _Pragma("unroll") for (int n = 0; n < 2; ++n) _Pragma("unroll") for (int k = 0; k < 2; ++k) \
        acc[ai][bj][m][n] = __builtin_amdgcn_mfma_f32_16x16x32_bf16(Bt[n][k], At[m][k], acc[ai][bj][m][n], 0, 0, 0); __builtin_amdgcn_s_setprio(0); } while (0)
#define PG8_WAIT_V(n) asm volatile("s_waitcnt vmcnt(" #n ")" ::: "memory")
#define PG8_WAIT_L(n) asm volatile("s_waitcnt lgkmcnt(" #n ")" ::: "memory")
#define PG8_BAR __builtin_amdgcn_s_barrier()
#define PG8_SCHED __builtin_amdgcn_sched_barrier(0)
    Unit cur, nxt; int ui = 0;
    if (!S.next(0, cur)) return;
    f32x4 acc[2][2][4][2];
#pragma unroll
    for (int a = 0; a < 2; ++a)
#pragma unroll
        for (int b = 0; b < 2; ++b)
#pragma unroll
            for (int m = 0; m < 4; ++m)
#pragma unroll
                for (int n = 0; n < 2; ++n) acc[a][b][m][n] = (f32x4){0.f, 0.f, 0.f, 0.f};
    bf16x8 At[4][2], B0[2][2], B1[2][2];
    const char* cA = (const char*)g.A + (size_t)cur.pm * tstep; const char* cB = (const char*)g.Bt + (size_t)cur.pn * tstep;
    S.a_ready(cur);
    if constexpr (SP2) {
        PG8_STAGE(PG8_SB(0, 0), cB, voffB); PG8_STAGE(PG8_SB(0, 1), cB + hstep, voffB); PG8_STAGE(PG8_SA(0, 0), cA, voffA); PG8_STAGE(PG8_SA(0, 1), cA + hstep, voffA);
        if (wr == 1) PG8_BAR;
        PG8_WAIT_V(2); PG8_BAR;
        PG8_STAGE(PG8_SB(1, 0), cB + kstep, voffB); PG8_STAGE(PG8_SA(1, 0), cA + kstep, voffA); PG8_STAGE(PG8_SB(1, 1), cB + hstep + kstep, voffB);
        PG8_WAIT_V(6); PG8_BAR;
    } else {
        PG8_STAGE(PG8_SB(0, 0), cB, voffB); PG8_STAGE(PG8_SA(0, 0), cA, voffA); PG8_STAGE(PG8_SB(0, 1), cB + hstep, voffB); PG8_STAGE(PG8_SA(0, 1), cA + hstep, voffA);
        if (wr == 1) PG8_BAR;
        PG8_WAIT_V(4); PG8_BAR;
        PG8_STAGE(PG8_SB(1, 0), cB + kstep, voffB); PG8_STAGE(PG8_SA(1, 0), cA + kstep, voffA); PG8_STAGE(PG8_SB(1, 1), cB + hstep + kstep, voffB);
        PG8_WAIT_V(6); PG8_BAR;
    }
    for (;;) {
        const bool has_next = S.next(ui + 1, nxt);
        const char* nA = has_next ? (const char*)g.A + (size_t)nxt.pm * tstep : cA; const char* nB = has_next ? (const char*)g.Bt + (size_t)nxt.pn * tstep : cB;
        for (int t = 0; t < nt; t += 2) {
            const bool last = (t == nt - 2);
            const char* a1 = cA + (size_t)(t + 1) * kstep;
            const char* a2 = last ? nA : cA + (size_t)(t + 2) * kstep; const char* b2 = last ? nB : cB + (size_t)(t + 2) * kstep;
            const char* a3 = a2 + kstep; const char* b3 = b2 + kstep;
            if (last && has_next) S.a_ready(nxt);
            if constexpr (SP2) {
            PG8_LDB(B0, 0, 0); PG8_LDB(B1, 0, 1); PG8_SCHED; PG8_LDA(At, 0, 0); PG8_STAGE(PG8_SA(1, 1), a1 + hstep, voffA);
            PG8_WAIT_V(8); PG8_WAIT_L(0); PG8_BAR; PG8_MMA(0, 0, At, B0); PG8_MMA(0, 1, At, B1); PG8_BAR; PG8_SCHED;
            PG8_LDA(At, 0, 1); PG8_STAGE(PG8_SB(0, 0), b2, voffB); PG8_STAGE(PG8_SB(0, 1), b2 + hstep, voffB); PG8_STAGE(PG8_SA(0, 0), a2, voffA);
            PG8_WAIT_V(8); PG8_WAIT_L(0); PG8_BAR; PG8_MMA(1, 0, At, B0); PG8_MMA(1, 1, At, B1); PG8_BAR; PG8_SCHED;
            PG8_LDB(B0, 1, 0); PG8_LDB(B1, 1, 1); PG8_SCHED; PG8_LDA(At, 1, 0); PG8_STAGE(PG8_SA(0, 1), a2 + hstep, voffA);
            PG8_WAIT_V(8); PG8_WAIT_L(0); PG8_BAR; PG8_MMA(0, 0, At, B0); PG8_MMA(0, 1, At, B1); PG8_BAR; PG8_SCHED;
            PG8_LDA(At, 1, 1); PG8_STAGE(PG8_SB(1, 0), b3, voffB); PG8_STAGE(PG8_SB(1, 1), b3 + hstep, voffB); PG8_STAGE(PG8_SA(1, 0), a3, voffA);
            PG8_WAIT_V(8); PG8_WAIT_L(0); PG8_BAR; PG8_MMA(1, 0, At, B0); PG8_MMA(1, 1, At, B1); PG8_BAR; PG8_SCHED;
            } else {
            PG8_LDB(B0, 0, 0); PG8_SCHED; PG8_LDA(At, 0, 0); PG8_STAGE(PG8_SA(1, 1), a1 + hstep, voffA);
            PG8_WAIT_L(8); PG8_BAR; PG8_WAIT_L(0); PG8_MMA(0, 0, At, B0); PG8_BAR; PG8_SCHED;
            PG8_LDB(B1, 0, 1); PG8_STAGE(PG8_SB(0, 0), b2, voffB);
            PG8_BAR; PG8_WAIT_L(0); PG8_MMA(0, 1, At, B1); PG8_BAR;
            PG8_LDA(At, 0, 1); PG8_STAGE(PG8_SA(0, 0), a2, voffA);
            PG8_BAR; PG8_WAIT_L(0); PG8_MMA(1, 0, At, B0); PG8_BAR; PG8_SCHED;
            PG8_STAGE(PG8_SB(0, 1), b2 + hstep, voffB);
            PG8_WAIT_V(6); PG8_BAR; PG8_MMA(1, 1, At, B1); PG8_BAR;
            PG8_LDB(B0, 1, 0); PG8_SCHED; PG8_LDA(At, 1, 0); PG8_STAGE(PG8_SA(0, 1), a2 + hstep, voffA);
            PG8_WAIT_L(8); PG8_BAR; PG8_WAIT_L(0); PG8_MMA(0, 0, At, B0); PG8_BAR; PG8_SCHED;
            PG8_LDB(B1, 1, 1); PG8_STAGE(PG8_SB(1, 0), b3, voffB);
            PG8_BAR; PG8_WAIT_L(0); PG8_MMA(0, 1, At, B1); PG8_BAR;
            PG8_LDA(At, 1, 1); PG8_STAGE(PG8_SA(1, 0), a3, voffA);
            PG8_BAR; PG8_WAIT_L(0); PG8_MMA(1, 0, At, B0); PG8_BAR; PG8_SCHED;
            PG8_STAGE(PG8_SB(1, 1), b3 + hstep, voffB);
            PG8_WAIT_V(6); PG8_BAR; PG8_MMA(1, 1, At, B1); PG8_BAR;
            }
        }
        if constexpr (ALIGN_EPI) { if (wr == 0) PG8_BAR; }
        if constexpr (!Epi::AFTER_DRAIN) { E(acc, cur, wr, wc, fr, fq); S.done(cur); }
        if (!has_next) break;
#pragma unroll
        for (int a = 0; a < 2; ++a)
#pragma unroll
            for (int b = 0; b < 2; ++b)
#pragma unroll
                for (int m = 0; m < 4; ++m)
#pragma unroll
                    for (int n = 0; n < 2; ++n) acc[a][b][m][n] = (f32x4){0.f, 0.f, 0.f, 0.f};
        cur = nxt; cA = nA; cB = nB; ++ui;
        if constexpr (ALIGN_EPI) { if (wr == 1) PG8_BAR; }
    }
    PG8_WAIT_V(0);
    if constexpr (!ALIGN_EPI) { if (wr == 0) PG8_BAR; }
    PG8_BAR;
    if constexpr (Epi::AFTER_DRAIN) { E.fused(acc, cur, wr, wc, fr, fq, lds, wid, lane); S.done(cur); }
#undef PG8_SA
#undef PG8_SB
#undef PG8_STAGE
#undef PG8_LDA
#undef PG8_LDB
#undef PG8_MMA
#undef PG8_WAIT_V
#undef PG8_WAIT_L
#undef PG8_BAR
#undef PG8_SCHED
}
}
#include <hip/hip_bf16.h>
#include <cmath>
namespace attn_body {
using bf16=__hip_bfloat16;
using bf16x8=__attribute__((ext_vector_type(8)))short;
using s16x4=__attribute__((ext_vector_type(4)))short;
using f32x16=__attribute__((ext_vector_type(16)))float;
using u32x4=__attribute__((ext_vector_type(4)))unsigned;
constexpr int D=64,QP=512,KP=64,OP=1024,SQ=4096,SKV=4352;
constexpr int NW=8,QBLK=32,QB=QBLK*NW,KVBLK=64,NQB=SQ/QB,NTILES=SKV/KVBLK;
constexpr int ATTN_UNIT_ROWS=QB;
__device__ __forceinline__ int crow(int r,int hi){return (r&3)+8*(r>>2)+4*hi;}
#define SBAR() __builtin_amdgcn_sched_barrier(0)
constexpr int NSLOT=3, SLOTB=8192;
constexpr int LDS_K=0, LDS_V=NSLOT*SLOTB, LDS_WS=2*NSLOT*SLOTB, LDS_OST=LDS_WS+NW*64*4, LDS_BYTES=LDS_OST+NW*4096;
constexpr float C2=0.125f*1.4426950408889634f;
__device__ __forceinline__ void glds16(const void*gsrc,unsigned lds_dst){unsigned keep;
  asm volatile("s_mov_b32 %0, m0\n\ts_mov_b32 m0, %2\n\ts_nop 0\n\tglobal_load_lds_dwordx4 %1, off\n\ts_mov_b32 m0, %0":"=&s"(keep):"v"(gsrc),"s"(lds_dst):"memory");}
__device__ __forceinline__ float max3f(float a,float b,float c){float r;asm("v_max3_f32 %0, %1, %2, %3":"=v"(r):"v"(a),"v"(b),"v"(c));return r;}
__device__ __forceinline__ float max2f(float a,float b){float r;asm("v_max_f32_e32 %0, %1, %2":"=v"(r):"v"(a),"v"(b));return r;}
__device__ __forceinline__ float fadd_s(float a,float b){float r;asm("v_add_f32_e32 %0, %1, %2":"=v"(r):"v"(a),"v"(b));return r;}
__device__ __forceinline__ float fsub_s(float a,float b){float r;asm("v_sub_f32_e32 %0, %1, %2":"=v"(r):"v"(a),"v"(b));return r;}
typedef float f32x2_t __attribute__((ext_vector_type(2))); typedef __bf16 bf16x2_t __attribute__((ext_vector_type(2)));
__device__ __forceinline__ unsigned cvtpk_s(float lo,float hi){f32x2_t v={lo,hi};bf16x2_t b=__builtin_convertvector(v,bf16x2_t);return __builtin_bit_cast(unsigned,b);}
#define WAIT_BAR(N) asm volatile("s_waitcnt vmcnt(" #N ") lgkmcnt(0)\n\ts_barrier":::"memory")

__device__ __forceinline__ void qkt(f32x16&p0,f32x16&p1,const char*Kslot,const bf16x8*qr,const f32x16&negm,int r32,int hi){
  const char*kb=Kslot+hi*1024+r32*16;
  #pragma unroll
  for(int d0=0;d0<4;++d0){
    const bf16x8 b0=*reinterpret_cast<const bf16x8*>(kb+d0*2048);
    const bf16x8 b1=*reinterpret_cast<const bf16x8*>(kb+d0*2048+512);
    if(d0==0){p0=__builtin_amdgcn_mfma_f32_32x32x16_bf16(b0,qr[0],negm,0,0,0);p1=__builtin_amdgcn_mfma_f32_32x32x16_bf16(b1,qr[0],negm,0,0,0);}
    else{p0=__builtin_amdgcn_mfma_f32_32x32x16_bf16(b0,qr[d0],p0,0,0,0);p1=__builtin_amdgcn_mfma_f32_32x32x16_bf16(b1,qr[d0],p1,0,0,0);}}
}
typedef __attribute__((address_space(3))) const char* lds_cptr;
typedef short v4i16_t __attribute__((ext_vector_type(4)));
__device__ __forceinline__ void kload8(bf16x8*kf,lds_cptr kp){
  kf[0]=*(const __attribute__((address_space(3))) bf16x8*)(kp);      kf[1]=*(const __attribute__((address_space(3))) bf16x8*)(kp+512);
  kf[2]=*(const __attribute__((address_space(3))) bf16x8*)(kp+2048); kf[3]=*(const __attribute__((address_space(3))) bf16x8*)(kp+2560);
  kf[4]=*(const __attribute__((address_space(3))) bf16x8*)(kp+4096); kf[5]=*(const __attribute__((address_space(3))) bf16x8*)(kp+4608);
  kf[6]=*(const __attribute__((address_space(3))) bf16x8*)(kp+6144); kf[7]=*(const __attribute__((address_space(3))) bf16x8*)(kp+6656);
}
__device__ __forceinline__ void kload2(bf16x8*kf,lds_cptr kp,int j){ kf[2*j]=*(const __attribute__((address_space(3))) bf16x8*)(kp+j*2048); kf[2*j+1]=*(const __attribute__((address_space(3))) bf16x8*)(kp+j*2048+512); }
__device__ __forceinline__ s16x4 vtr(lds_cptr p){ return __builtin_bit_cast(s16x4,__builtin_amdgcn_ds_read_tr16_b64_v4i16((__attribute__((address_space(3))) v4i16_t*)p)); }
__device__ __forceinline__ float rowmax(const f32x16&p0,const f32x16&p1){
  float a=max3f(p0[0],p0[1],p1[0]),b=max3f(p0[2],p0[3],p1[1]);a=max3f(a,p1[2],p1[3]);
  #pragma unroll
  for(int r=4;r<16;r+=4){a=max3f(a,p0[r],p0[r+1]);b=max3f(b,p0[r+2],p0[r+3]);a=max3f(a,p1[r],p1[r+1]);b=max3f(b,p1[r+2],p1[r+3]);}
  const float m=max2f(a,b);
  auto rr=__builtin_amdgcn_permlane32_swap(__float_as_uint(m),__float_as_uint(m),false,false);
  return max2f(__uint_as_float(rr[0]),__uint_as_float(rr[1]));
}
__device__ __forceinline__ void pv(f32x16*o,int vb,bf16x8 pa0,bf16x8 pa1,bf16x8 pa2,bf16x8 pa3){
  #pragma unroll
  for(int d0=0;d0<2;++d0){s16x4 lo[4],hi[4];
    #pragma unroll
    for(int ks=0;ks<4;++ks){
      asm volatile("ds_read_b64_tr_b16 %0,%1 offset:%c2":"=&v"(lo[ks]):"v"(vb),"i"(d0*4096+ks*1024):"memory");
      asm volatile("ds_read_b64_tr_b16 %0,%1 offset:%c2":"=&v"(hi[ks]):"v"(vb),"i"(d0*4096+ks*1024+512):"memory");}
    asm volatile("s_waitcnt lgkmcnt(0)":::"memory");SBAR();
    #define PK(k) (bf16x8){lo[k][0],lo[k][1],lo[k][2],lo[k][3],hi[k][0],hi[k][1],hi[k][2],hi[k][3]}
    o[d0]=__builtin_amdgcn_mfma_f32_32x32x16_bf16(pa0,PK(0),o[d0],0,0,0);
    o[d0]=__builtin_amdgcn_mfma_f32_32x32x16_bf16(pa1,PK(1),o[d0],0,0,0);
    o[d0]=__builtin_amdgcn_mfma_f32_32x32x16_bf16(pa2,PK(2),o[d0],0,0,0);
    o[d0]=__builtin_amdgcn_mfma_f32_32x32x16_bf16(pa3,PK(3),o[d0],0,0,0);
    #undef PK
  }
}

#ifndef ATTN_STORE16
#define ATTN_STORE16(p,v) (*(u32x4*)(p)=(v))
#endif
template<int THRL> __device__ __forceinline__ void attn_unit(int b,int h,int qb,const bf16*Q,const bf16*__restrict__ K,const bf16*__restrict__ V,bf16*O,char*shm){
  int tid_=threadIdx.x; asm volatile("":"+v"(tid_)); const int tid=tid_,lane=tid&63,r32=lane&31,hi=lane>>5; const int wid=__builtin_amdgcn_readfirstlane(tid>>6);
  const long rowbase=(long)b*SQ; const int q0=qb*QB;
  const bf16*Qw=Q+(rowbase+q0+wid*QBLK)*QP+h*D;
  const long kvbase=(long)(b*2+(h>>2))*SKV*KP; const bf16*Kh=K+kvbase,*Vh=V+kvbase;
  const unsigned lds0=(unsigned)(uintptr_t)shm;
  float*wsf=(float*)(shm+LDS_WS)+wid*64;
  const bf16*ksrc=Kh+(long)lane*KP+wid*8;
  const bf16*vsrc=Vh+(long)(16*(wid&3)+(lane>>2))*KP+(wid>>2)*32+(lane&3)*8;
  const unsigned kdst=lds0+LDS_K+wid*1024, vdst=lds0+LDS_V+wid*1024;
  #define DMA_K(t,slot) glds16(ksrc+(long)(t)*KVBLK*KP,(unsigned)__builtin_amdgcn_readfirstlane(kdst+(slot)))
  #define DMA_V(t,slot) glds16(vsrc+(long)(t)*KVBLK*KP,(unsigned)__builtin_amdgcn_readfirstlane(vdst+(slot)))
  const int vb0=(int)(lds0+LDS_V)+((lane>>4)&1)*32+(lane&3)*8+(4*hi+((lane&15)>>2))*64;
  const char*Kbase=shm+LDS_K; bf16x8 kf[8];
  const lds_cptr shm3=(lds_cptr)shm; const lds_cptr kp0=shm3+LDS_K+hi*1024+r32*16; const lds_cptr vp0=shm3+LDS_V+((lane>>4)&1)*32+(lane&3)*8+(4*hi+((lane&15)>>2))*64;
  constexpr int NT=NTILES;
  DMA_K(0,0);DMA_V(0,0);DMA_K(1,SLOTB);
  bf16x8 qr[4];
  #pragma unroll
  for(int d0=0;d0<4;++d0)qr[d0]=*reinterpret_cast<const bf16x8*>(&Qw[(long)r32*QP+d0*16+hi*8]);
  float mhat=0.f,l_reg=0.f;f32x16 o[2];o[0]=f32x16{};o[1]=f32x16{};f32x16 negm=f32x16{};asm volatile("":"+v"(negm));
  #define CMASK(P0,P1,t) do{}while(0)
  bool resc=false;
  #define START(P0,P1) do{ const float rm=rowmax(P0,P1); resc=false; \
    { const float dl=rm; mhat=fadd_s(mhat,dl); \
      _Pragma("unroll") for(int r=0;r<16;++r){P0[r]=fsub_s(P0[r],dl);P1[r]=fsub_s(P1[r],dl);} \
      _Pragma("unroll") for(int r=0;r<16;++r)negm[r]=-mhat; asm volatile("":"+v"(negm)); } \
    _Pragma("unroll") for(int r=0;r<16;++r)P0[r]=__builtin_amdgcn_exp2f(P0[r]); }while(0)
  #define RESC() do{ if(resc){ asm volatile("s_waitcnt lgkmcnt(0)":::"memory"); \
      _Pragma("unroll") for(int d_=0;d_<2;++d_) _Pragma("unroll") for(int r=0;r<16;++r)o[d_][r]*=wsf[crow(r,hi)]; } }while(0)
  f32x16 pA0,pA1,pB0,pB1;
  int sl_prev=0,sl_cur=0,sl_next=SLOTB;
  #define ROT() do{sl_prev=sl_cur;sl_cur=sl_next;sl_next=(sl_next==(NSLOT-1)*SLOTB)?0:sl_next+SLOTB;}while(0)
  DMA_K(2,2*SLOTB);
  WAIT_BAR(3);
  qkt(pA0,pA1,Kbase,qr,negm,r32,hi);asm volatile("s_nop 15\n\ts_nop 7":"+v"(pA0),"+v"(pA1));CMASK(pA0,pA1,0);
  START(pA0,pA1);
  _Pragma("unroll") for(int r=0;r<16;++r)pA1[r]=__builtin_amdgcn_exp2f(pA1[r]);
  WAIT_BAR(0);
  DMA_K(3,0);DMA_V(1,SLOTB);
  ROT();
  kload8(kf,kp0+sl_cur);
  WAIT_BAR(2);
  s16x4 vlo[8],vhi[8]; u32x4 pw0,pw1,pw2,pw3;
  #define PKW(P,B) cvtpk_s(P[B],P[B+1])
  #define PAF(k) __builtin_bit_cast(bf16x8,pw##k)
  #define VFR(i) (bf16x8){vlo[i][0],vlo[i][1],vlo[i][2],vlo[i][3],vhi[i][0],vhi[i][1],vhi[i][2],vhi[i][3]}
  #define PIN(x) asm volatile("":"+v"(x))
  #define MX3(a,b,c) __builtin_fmaxf(__builtin_fmaxf((a),(b)),(c))
  #define GAPA(MF,A0,A1,A2,A3,W0,W1,PW) do{ MF; sacc+=A0; sacc+=A1; sacc+=A2; sacc+=A3; PIN(sacc); W0; W1; PIN(PW); SBAR(); }while(0)
  #define EX(v) __builtin_amdgcn_exp2f(v)
  #define GAPB(MF,X,B) do{ MF; X[B]=EX(X[B]); X[B+1]=EX(X[B+1]); X[B+2]=EX(X[B+2]); X[B+3]=EX(X[B+3]); PIN(X); SBAR(); }while(0)
  #define VRD(i) do{ vlo[i]=vtr(vp_+(((i)>>2)*4096+((i)&3)*1024)); vhi[i]=vtr(vp_+(((i)>>2)*4096+((i)&3)*1024+512)); }while(0)
  #define KRD(G,j) do{ if(G){ kload2(kf,kp0+sl_next,j); SBAR(); } }while(0)
  #define STEP(C0,C1,P0,P1,t,GK,GV,GL) do{ SBAR(); \
    const lds_cptr vp_=vp0+sl_prev; \
    VRD(0); SBAR(); float sacc=(P0[0]+P0[1]); \
    GAPA(C0=__builtin_amdgcn_mfma_f32_32x32x16_bf16(kf[0],qr[0],negm,0,0,0), P0[2],P0[3],P0[4],P0[5],     pw0[0]=PKW(P0,0), pw0[1]=PKW(P0,2), pw0); \
    VRD(4); SBAR(); GAPA(C1=__builtin_amdgcn_mfma_f32_32x32x16_bf16(kf[1],qr[0],negm,0,0,0), P0[6],P0[7],P0[8],P0[9],     pw0[2]=PKW(P0,4), pw0[3]=PKW(P0,6), pw0); \
    VRD(1); SBAR(); GAPA(C0=__builtin_amdgcn_mfma_f32_32x32x16_bf16(kf[2],qr[1],C0,0,0,0),   P0[10],P0[11],P0[12],P0[13], pw1[0]=PKW(P0,8), pw1[1]=PKW(P0,10), pw1); \
    VRD(5); SBAR(); GAPA(C1=__builtin_amdgcn_mfma_f32_32x32x16_bf16(kf[3],qr[1],C1,0,0,0),   P0[14],P0[15],P1[0],P1[1],   pw1[2]=PKW(P0,12),pw1[3]=PKW(P0,14), pw1); \
    VRD(2); SBAR(); GAPA(C0=__builtin_amdgcn_mfma_f32_32x32x16_bf16(kf[4],qr[2],C0,0,0,0),   P1[2],P1[3],P1[4],P1[5],     pw2[0]=PKW(P1,0), pw2[1]=PKW(P1,2), pw2); \
    VRD(6); SBAR(); GAPA(C1=__builtin_amdgcn_mfma_f32_32x32x16_bf16(kf[5],qr[2],C1,0,0,0),   P1[6],P1[7],P1[8],P1[9],     pw2[2]=PKW(P1,4), pw2[3]=PKW(P1,6), pw2); \
    VRD(3); SBAR(); GAPA(C0=__builtin_amdgcn_mfma_f32_32x32x16_bf16(kf[6],qr[3],C0,0,0,0),   P1[10],P1[11],P1[12],P1[13], pw3[0]=PKW(P1,8), pw3[1]=PKW(P1,10), pw3); \
    VRD(7); SBAR(); GAPA(C1=__builtin_amdgcn_mfma_f32_32x32x16_bf16(kf[7],qr[3],C1,0,0,0),   P1[14],P1[15],0.f,0.f,       pw3[2]=PKW(P1,12),pw3[3]=PKW(P1,14), pw3); \
    l_reg+=sacc; \
    if(GK){DMA_K((t)+3,sl_cur);} if(GV){DMA_V((t)+1,sl_next);} \
    CMASK(C0,C1,t); \
    { float a=MX3(C0[0],C0[1],C1[0]),b=MX3(C0[2],C0[3],C1[1]); a=MX3(a,C1[2],C1[3]); \
      _Pragma("unroll") for(int r=4;r<16;r+=4){a=MX3(a,C0[r],C0[r+1]);b=MX3(b,C0[r+2],C0[r+3]);a=MX3(a,C1[r],C1[r+1]);b=MX3(b,C1[r+2],C1[r+3]);} \
      float rm=__builtin_fmaxf(a,b); { auto rr=__builtin_amdgcn_permlane32_swap(__float_as_uint(rm),__float_as_uint(rm),false,false); rm=__builtin_fmaxf(__uint_as_float(rr[0]),__uint_as_float(rr[1])); } \
      resc=false; \
      if(__builtin_expect(__any(rm>(float)THRL),0)){ const float dl=__builtin_fmaxf(rm,0.f); mhat+=dl; \
        _Pragma("unroll") for(int r=0;r<16;++r){C0[r]-=dl;C1[r]-=dl;} \
        _Pragma("unroll") for(int r=0;r<16;++r)negm[r]=-mhat; asm volatile("":"+v"(negm)); \
        const float f=__builtin_amdgcn_exp2f(-dl); l_reg*=f; if(hi==0)wsf[r32]=f; resc=true; } } \
    SBAR(); \
    GAPB(o[0]=__builtin_amdgcn_mfma_f32_32x32x16_bf16(PAF(0),VFR(0),o[0],0,0,0), C0,0); \
    GAPB(o[1]=__builtin_amdgcn_mfma_f32_32x32x16_bf16(PAF(0),VFR(4),o[1],0,0,0), C0,4); \
    KRD(GL,0); GAPB(o[0]=__builtin_amdgcn_mfma_f32_32x32x16_bf16(PAF(1),VFR(1),o[0],0,0,0), C0,8); \
    KRD(GL,1); GAPB(o[1]=__builtin_amdgcn_mfma_f32_32x32x16_bf16(PAF(1),VFR(5),o[1],0,0,0), C0,12); \
    KRD(GL,2); GAPB(o[0]=__builtin_amdgcn_mfma_f32_32x32x16_bf16(PAF(2),VFR(2),o[0],0,0,0), C1,0); \
    KRD(GL,3); GAPB(o[1]=__builtin_amdgcn_mfma_f32_32x32x16_bf16(PAF(2),VFR(6),o[1],0,0,0), C1,4); \
    GAPB(o[0]=__builtin_amdgcn_mfma_f32_32x32x16_bf16(PAF(3),VFR(3),o[0],0,0,0), C1,8); \
    GAPB(o[1]=__builtin_amdgcn_mfma_f32_32x32x16_bf16(PAF(3),VFR(7),o[1],0,0,0), C1,12); \
    }while(0)
  int t=1;
  #undef CMASK
  #define CMASK(P0,P1,t) do{}while(0)
  for(;t+5<NT;t+=2){
    STEP(pB0,pB1,pA0,pA1,t,true,true,true);     WAIT_BAR(2); RESC(); ROT();
    STEP(pA0,pA1,pB0,pB1,t+1,true,true,true);   WAIT_BAR(2); RESC(); ROT();
  }
  #undef CMASK
  #define CMASK(P0,P1,t) do{}while(0)
  #define ENDW(tt) do{ if((tt)+3<NT){WAIT_BAR(2);} else if((tt)+2<NT){WAIT_BAR(1);} else {WAIT_BAR(0);} }while(0)
  for(;t+1<NT;t+=2){
    STEP(pB0,pB1,pA0,pA1,t,(t+3<NT),(t+1<NT),(t+1<NT));       ENDW(t);   RESC(); ROT();
    STEP(pA0,pA1,pB0,pB1,t+1,(t+4<NT),(t+2<NT),(t+2<NT));     ENDW(t+1); RESC(); ROT();
  }
  STEP(pB0,pB1,pA0,pA1,NT-1,false,false,false); RESC();
  { float sacc=pB0[0]+pB0[1]; _Pragma("unroll") for(int r=2;r<16;++r)sacc+=pB0[r]; _Pragma("unroll") for(int r=0;r<16;++r)sacc+=pB1[r]; l_reg+=sacc;
    pw0=(u32x4){PKW(pB0,0),PKW(pB0,2),PKW(pB0,4),PKW(pB0,6)};pw1=(u32x4){PKW(pB0,8),PKW(pB0,10),PKW(pB0,12),PKW(pB0,14)};pw2=(u32x4){PKW(pB1,0),PKW(pB1,2),PKW(pB1,4),PKW(pB1,6)};pw3=(u32x4){PKW(pB1,8),PKW(pB1,10),PKW(pB1,12),PKW(pB1,14)};
    SBAR(); pv(o,vb0+sl_cur,PAF(0),PAF(1),PAF(2),PAF(3)); }
  #undef PKW
  #undef PAF
  #undef VFR
  #undef PIN
  #undef MX3
  #undef GAPA
  #undef GAPB
  #undef EX
  #undef VRD
  #undef KRD
  #undef STEP
  #undef ENDW
  {auto rr=__builtin_amdgcn_permlane32_swap(__float_as_uint(l_reg),__float_as_uint(l_reg),false,false);l_reg=__uint_as_float(rr[0])+__uint_as_float(rr[1]);}
  if(hi==0)wsf[32+r32]=l_reg;asm volatile("s_waitcnt lgkmcnt(0)":::"memory");
  float rli[16];
  #pragma unroll
  for(int r=0;r<16;++r)rli[r]=__builtin_amdgcn_rcpf(wsf[32+crow(r,hi)]);
  bf16*Ow=O+(rowbase+q0+wid*QBLK)*OP+h*D;
  { bf16*stg=(bf16*)(shm+LDS_OST)+wid*2048;
    #pragma unroll
    for(int r=0;r<16;++r){const int orow=crow(r,hi);
      #pragma unroll
      for(int d0=0;d0<2;++d0)stg[orow*64+d0*32+r32]=__float2bfloat16(o[d0][r]*rli[r]);}
    asm volatile("s_waitcnt lgkmcnt(0)":::"memory");
    #pragma unroll
    for(int i=0;i<4;++i){const int row=i*8+(lane>>3),ch=lane&7; const u32x4 v=*(const u32x4*)(stg+row*64+ch*8); ATTN_STORE16(Ow+(long)row*OP+ch*8,v);} }
  asm volatile("s_waitcnt lgkmcnt(0)\n\ts_barrier":::"memory");
  #undef DMA_K
  #undef DMA_V
  #undef CMASK
  #undef START
  #undef RESC
  #undef ROT
}
constexpr int ATTN_LDS_BYTES=LDS_BYTES;
struct AttnTensors { const bf16* Q; const bf16* K; const bf16* V; bf16* O; };
struct AttnUnit { int bh; int qb; };
struct StaticOrder {
  int vcu,G;
  __device__ __forceinline__ explicit StaticOrder(int grid,int block):vcu((grid%8==0)?(block%8)*(grid/8)+block/8:block),G(grid){}
  __device__ __forceinline__ bool next(int i,AttnUnit&u)const{ const int per=(8*8*NQB+G-1)/G; if(i>=per)return false; const int id=vcu*per+i; if(id>=8*8*NQB)return false; u.bh=id/NQB; u.qb=id%NQB; return true; }
  __device__ __forceinline__ void a_ready(const AttnUnit&)const{}
  __device__ __forceinline__ void done(const AttnUnit&)const{}
};
template<class Sched,int THRL=8> __device__ __forceinline__ void attn_phase(char*lds,const AttnTensors&T,const Sched&S){
  AttnUnit u;
  for(int i=0;S.next(i,u);++i){ S.a_ready(u); attn_unit<THRL>(u.bh>>3,u.bh&7,u.qb,T.Q,T.K,T.V,T.O,lds); S.done(u); }
}
#undef SBAR
#undef WAIT_BAR
}
constexpr int NWAVES = 8;
#ifndef MK_PER_PHASE
#define MK_PER_PHASE 1
#endif
constexpr int N_PHASES = 18;

constexpr int NB = 8, SEQ = 4096, DM = 1024, M = NB * SEQ, CTXL = 256, MC = NB * CTXL, MA = M + MC;
constexpr int NQH = 8, NKVH = 2, HD = 64, AW = 512, KVW = 128, SGW = 512, INW = 1792, SKV = CTXL + SEQ;
constexpr int DFF = 2816, NMOD = 6 * DM;
constexpr float EPS = 1e-6f;
constexpr float QSCALE = 0.125f * 1.4426950408889634f;

constexpr size_t MiB = 1u << 20;
constexpr size_t WS_CTL = 0, CTL_ZERO_BYTES = 1 * MiB;
constexpr size_t WS_MOD = 1 * MiB;
constexpr size_t WS_ROPE = 1 * MiB + 458752;
constexpr size_t WS_WIN = 2 * MiB, WS_WOUT = 6 * MiB, WS_WFI0 = 8 * MiB, WS_WFI1 = 19 * MiB, WS_WFO0 = 30 * MiB, WS_WFO1 = 36 * MiB, WS_WPW1 = 42 * MiB, WS_WPW2 = 46 * MiB, WS_WSP = 48 * MiB;
constexpr size_t WS_XM = 50 * MiB;
constexpr size_t WS_RAW = 118 * MiB;
constexpr size_t WS_Q = 237 * MiB, WS_K = 269 * MiB, WS_V = 278 * MiB, WS_U = 287 * MiB, WS_VN = 319 * MiB, WS_CAT = 351 * MiB;
constexpr size_t WS_ACT = 118 * MiB;
constexpr size_t WS_G = 415 * MiB;
constexpr size_t WS_END = 479 * MiB;
static_assert(WS_XM + (size_t)MA * DM * 2 <= WS_RAW && WS_RAW + (size_t)MA * INW * 2 <= WS_Q && WS_K + (size_t)NB * NKVH * SKV * HD * 2 <= WS_V && WS_V + (size_t)NB * NKVH * SKV * HD * 2 <= WS_U, "ws map");
static_assert(WS_ACT + (size_t)M * DFF * 2 <= WS_CAT && WS_CAT + (size_t)M * DM * 2 <= WS_G && WS_G + (size_t)M * DM * 2 <= WS_END && WS_ACT + (size_t)M * DM * 4 <= WS_CAT, "ws map 2");
constexpr int CW_BAR = 4096;

constexpr int RING_OFF = 0, RING_BYTES = 131072;
constexpr int LDSCTL_OFF = RING_BYTES, MISC_OFF = LDSCTL_OFF + 320;
constexpr int LDS_BYTES = 147456;
static_assert(MISC_OFF + 128 <= LDS_BYTES, "LDS map");
#define GAS __attribute__((address_space(1)))
#define LAS __attribute__((address_space(3)))
typedef unsigned short bf16;
typedef unsigned v4u __attribute__((ext_vector_type(4)));
typedef float f32x4 __attribute__((ext_vector_type(4)));
typedef short bf16x8 __attribute__((ext_vector_type(8)));
typedef GAS unsigned gu32;
typedef GAS unsigned long long gu64;
#define RLX_AGENT __ATOMIC_RELAXED, __HIP_MEMORY_SCOPE_AGENT
#define LDS_WAIT() asm volatile("s_waitcnt lgkmcnt(0)" ::: "memory")
#define VM_WAIT() asm volatile("s_waitcnt vmcnt(0)" ::: "memory")
__device__ __forceinline__ unsigned long long rt() { return __builtin_amdgcn_s_memrealtime(); }
__device__ __forceinline__ unsigned f2bf(float f) { unsigned u = __builtin_bit_cast(unsigned, f); return (u + 0x7fffu + ((u >> 16) & 1u)) >> 16; }
__device__ __forceinline__ unsigned pk2(float lo, float hi) { return f2bf(lo) | (f2bf(hi) << 16); }

#define XB_TMO      128
#define XB_XCNT(j)  (256  + 64 * (j))
#define XB_XSUB(j)  (1280 + 64 * (j))
#define XB_XGEN(j)  (2304 + 64 * (j))
#define XB_TOP      3328
#define XB_TOPGEN   3392
#define XCD_BAR_WORDS 3456
#define XB_SPIN_CAP (1u << 18)

__device__ __forceinline__ unsigned xb_ld(unsigned* p)              { return __hip_atomic_load(p, __ATOMIC_RELAXED, __HIP_MEMORY_SCOPE_AGENT); }
__device__ __forceinline__ unsigned xb_add(unsigned* p, unsigned v) { return __hip_atomic_fetch_add(p, v, __ATOMIC_RELAXED, __HIP_MEMORY_SCOPE_AGENT); }
__device__ __forceinline__ unsigned xb_xcc_id() { return (unsigned)__builtin_amdgcn_s_getreg((3 << 11) | 20) & 0xFu; }
#define XB_SPIN(cond, bar) do { unsigned _sp = 0; while (cond) { __builtin_amdgcn_s_sleep(1); \
    if ((++_sp & 255u) == 0u) { if (xb_ld(&(bar)[XB_TMO])) break; if (_sp > XB_SPIN_CAP) { atomicAdd(&(bar)[XB_TMO], 1u); break; } } } } while (0)

struct XcdBarrier {
    unsigned* bar; unsigned x;
    volatile LAS unsigned* st;
};

__device__ __forceinline__ XcdBarrier xcd_barrier_post(unsigned* bar, volatile LAS unsigned* st) {
    XcdBarrier b; b.bar = bar; b.x = xb_xcc_id(); b.st = st;
    if (threadIdx.x == 0) (void)xb_add(&bar[XB_XCNT(b.x)], 1u);
    return b;
}
__device__ __forceinline__ void xcd_barrier_complete(unsigned* bar, unsigned x, unsigned& nloc, unsigned& nx) {
    const unsigned G = gridDim.x * gridDim.y * gridDim.z;
    unsigned sum, cnt, mine, sp = 0u;
    for (;;) {
        sum = 0u; cnt = 0u; mine = 0u;
#pragma unroll
        for (unsigned j = 0; j < 16; ++j) { const unsigned c = xb_ld(&bar[XB_XCNT(j)]); sum += c; cnt += (c > 0u) ? 1u : 0u; mine = (j == x) ? c : mine; }
        if (sum == G) break;
        __builtin_amdgcn_s_sleep(1);
        if ((++sp & 255u) == 0u) { if (xb_ld(&bar[XB_TMO])) break; if (sp > XB_SPIN_CAP) { atomicAdd(&bar[XB_TMO], 1u); break; } }
    }
    nloc = mine > 0u ? mine : 1u; nx = cnt > 0u ? cnt : 1u;
}

__device__ __forceinline__ void xcd_barrier(const XcdBarrier& b) {
    asm volatile("s_waitcnt vmcnt(0)" ::: "memory");
    __syncthreads();
    if (threadIdx.x == 0) {
        unsigned* bar = b.bar;
        __builtin_amdgcn_s_waitcnt(0);
        unsigned nloc = b.st[0], nx = b.st[1];
        if (nloc == 0u) { xcd_barrier_complete(bar, b.x, nloc, nx); b.st[0] = nloc; b.st[1] = nx; }
        const unsigned old = xb_add(&bar[XB_XSUB(b.x)], 1u);
        const unsigned gen = old / nloc;
        if (old + 1u == (gen + 1u) * nloc) {
            __builtin_amdgcn_fence(__ATOMIC_RELEASE, "agent");
            asm volatile("s_waitcnt vmcnt(0)" ::: "memory");
            const unsigned og = xb_add(&bar[XB_TOP], 1u);
            const unsigned tg = og / nx;
            if (og + 1u == (tg + 1u) * nx) xb_add(&bar[XB_TOPGEN], 1u);
            else XB_SPIN(xb_ld(&bar[XB_TOPGEN]) == tg, bar);
            __builtin_amdgcn_fence(__ATOMIC_ACQUIRE, "agent");
            xb_add(&bar[XB_XGEN(b.x)], 1u);
            asm volatile("s_waitcnt vmcnt(0)" ::: "memory");
        } else {
            XB_SPIN(xb_ld(&bar[XB_XGEN(b.x)]) == gen, bar);
            __builtin_amdgcn_fence(__ATOMIC_ACQUIRE, "agent");
            asm volatile("s_waitcnt vmcnt(0)" ::: "memory");
        }
    }
    __syncthreads();
}
struct Args { const float* in[25]; float* out; unsigned char* ws; int ph_lo, ph_hi; };
static_assert(sizeof(Args) == 25 * 8 + 8 + 8 + 8, "Args has no padding");
typedef const __attribute__((address_space(4))) Args* KArgs;
#define INP(i) (((KArgs)__builtin_amdgcn_kernarg_segment_ptr())->in[i])
typedef float f32x2 __attribute__((ext_vector_type(2)));
struct Frame {
    LAS unsigned char* lds;
    volatile LAS unsigned* MISC;
    gu32* ctl;
    int tid, lane, wave, vcu, G;
    float* out; unsigned char* ws;
};
#define IN_X 0
#define IN_C 1
#define IN_CTX 2
#define IN_CCTX 3
#define IN_WMOD 4
#define IN_BMOD 5
#define IN_GMIX 6
#define IN_GFFN 7
#define IN_WFI 8
#define IN_WFO 9
#define IN_WIN 10
#define IN_QG 11
#define IN_KG 12
#define IN_WSP 13
#define IN_BSP 14
#define IN_WOUT 15
#define IN_WPW1 16
#define IN_BPW1 17
#define IN_WDW 18
#define IN_BDW 19
#define IN_LNG 20
#define IN_LNB 21
#define IN_WPW2 22
#define IN_BPW2 23
#define IN_GFIN 24
__device__ __forceinline__ float bf2f(unsigned short h) { return __uint_as_float((unsigned)h << 16); }
__device__ __forceinline__ float bflo(unsigned w) { return __uint_as_float(w << 16); }
__device__ __forceinline__ float bfhi(unsigned w) { return __uint_as_float(w & 0xffff0000u); }
__device__ __forceinline__ float wave_sum(float v) {
#pragma unroll
    for (int o = 1; o < 64; o <<= 1) v += __shfl_xor(v, o);
    return v;
}
__device__ __forceinline__ float gelu_tanh(float x) {
    const float u = 0.7978845608028654f * (x + 0.044715f * x * x * x);
    return x * __builtin_amdgcn_rcpf(1.0f + __builtin_amdgcn_exp2f(-2.0f * 1.4426950408889634f * u));
}
__device__ __forceinline__ float silu_f(float x) { return x * __builtin_amdgcn_rcpf(1.0f + __builtin_amdgcn_exp2f(-1.4426950408889634f * x)); }
__device__ __forceinline__ const float* modp(const Frame& F, int l, int r, int chunk) { return (const float*)(F.ws + WS_MOD) + ((size_t)(l * 9 + r) * NMOD + chunk * DM); }

__device__ __forceinline__ void p0_mod_item(Frame& F, int item) {
    const int l = item / 48, n0 = (item % 48) * 128;
    LAS float* S = (LAS float*)F.lds;
    LAS float* P = (LAS float*)(F.lds + 40960);
    for (int idx = F.tid; idx < 9 * 1024; idx += NWAVES * 64) { const int r = idx >> 10, k = idx & 1023; const float v = r < 8 ? INP(IN_C)[r * 1024 + k] : INP(IN_CCTX)[k]; S[idx] = silu_f(v); }
    __syncthreads();
    const float* W = INP(IN_WMOD) + (size_t)l * DM * NMOD + n0 + 2 * F.lane;
    float a0[9], a1[9];
#pragma unroll
    for (int r = 0; r < 9; ++r) { a0[r] = 0.f; a1[r] = 0.f; }
    const int kb = F.wave * 128;
#pragma unroll 2
    for (int kk = 0; kk < 128; kk += 8) {
        f32x2 wv[8];
#pragma unroll
        for (int i = 0; i < 8; ++i) wv[i] = *(const f32x2*)(W + (size_t)(kb + kk + i) * NMOD);
#pragma unroll
        for (int r = 0; r < 9; ++r) {
            const f32x4 s0 = *(const LAS f32x4*)(S + r * 1024 + kb + kk), s1 = *(const LAS f32x4*)(S + r * 1024 + kb + kk + 4);
#pragma unroll
            for (int i = 0; i < 4; ++i) { a0[r] += s0[i] * wv[i].x; a1[r] += s0[i] * wv[i].y; }
#pragma unroll
            for (int i = 0; i < 4; ++i) { a0[r] += s1[i] * wv[4 + i].x; a1[r] += s1[i] * wv[4 + i].y; }
        }
    }
#pragma unroll
    for (int r = 0; r < 9; ++r) { P[(F.wave * 9 + r) * 128 + 2 * F.lane] = a0[r]; P[(F.wave * 9 + r) * 128 + 2 * F.lane + 1] = a1[r]; }
    __syncthreads();
    float* MODO = (float*)(F.ws + WS_MOD);
    for (int idx = F.tid; idx < 9 * 128; idx += NWAVES * 64) { const int r = idx >> 7, c = idx & 127; float s = INP(IN_BMOD)[l * NMOD + n0 + c];
#pragma unroll
        for (int w = 0; w < 8; ++w) s += P[(w * 9 + r) * 128 + c];
        MODO[(size_t)(l * 9 + r) * NMOD + n0 + c] = s; }
    __syncthreads();
}
__device__ __forceinline__ void p0_transpose_item(const float* W, int K, int N, bf16* WT, int k0, int n0, int prow0, LAS float* scr, int lane) {
#pragma unroll 8
    for (int i = 0; i < 32; ++i) { const int kk = 2 * i + (lane >> 5); scr[kk * 33 + (lane & 31)] = W[(size_t)(k0 + kk) * N + n0 + (lane & 31)]; }
    LDS_WAIT(); asm volatile("" ::: "memory");
    const int c = lane & 7;
#pragma unroll
    for (int j = 0; j < 4; ++j) { const int n = (lane >> 3) + 8 * j; const LAS float* s = scr + (8 * c) * 33 + n;
        v4u o; o.x = pk2(s[0 * 33], s[1 * 33]); o.y = pk2(s[2 * 33], s[3 * 33]); o.z = pk2(s[4 * 33], s[5 * 33]); o.w = pk2(s[6 * 33], s[7 * 33]);
        *(v4u*)(WT + (size_t)(prow0 + n) * K + k0 + 8 * c) = o; }
    LDS_WAIT(); asm volatile("" ::: "memory");
}
__device__ __forceinline__ int gated_row(int n, int H) { const int h = n >= H, j = n - h * H; return 256 * (j >> 7) + 128 * h + (j & 127); }
__device__ __forceinline__ void p0_prologue(Frame& F) {
    if (F.vcu < 96) p0_mod_item(F, F.vcu);
    const int gt = F.vcu * (NWAVES * 64) + F.tid, NGT = F.G * NWAVES * 64;
    if (gt < 1024) { const int pos = gt >> 4, i = gt & 15; const float inv = exp2f(-(float)(2 * i) * (13.287712379549449f / 32.0f)); float sn, cs; sincosf((float)pos * inv, &sn, &cs);
        float* R = (float*)(F.ws + WS_ROPE); R[2 * gt] = cs; R[2 * gt + 1] = sn; }
    { bf16* WSPB = (bf16*)(F.ws + WS_WSP); for (int i = gt; i < 4 * 128 * 128; i += NGT) WSPB[i] = (bf16)f2bf(INP(IN_WSP)[i]); }
    LAS float* scr = (LAS float*)(F.lds + RING_OFF + F.wave * 16384);
    const int gw = F.vcu * NWAVES + F.wave, NGW = F.G * NWAVES;
    constexpr int I_IN = 16 * (INW / 32), I_OUT = 16 * 32, I_FI = 16 * (2 * DFF / 32), I_FO = (DFF / 64) * 32, I_P1 = 16 * 64, I_P2 = 16 * 32;
    constexpr int NITEMS = I_IN + I_OUT + 2 * I_FI + 2 * I_FO + I_P1 + I_P2;
    for (int it = gw; it < NITEMS; it += NGW) {
        int r = it;
        if (r < I_IN) { const int nb = INW / 32, k0 = 64 * (r / nb), n0 = 32 * (r % nb); p0_transpose_item(INP(IN_WIN), DM, INW, (bf16*)(F.ws + WS_WIN), k0, n0, n0, scr, F.lane); continue; } r -= I_IN;
        if (r < I_OUT) { const int nb = 32, k0 = 64 * (r / nb), n0 = 32 * (r % nb); p0_transpose_item(INP(IN_WOUT), DM, DM, (bf16*)(F.ws + WS_WOUT), k0, n0, n0, scr, F.lane); continue; } r -= I_OUT;
        if (r < 2 * I_FI) { const int l = r / I_FI; r -= l * I_FI; const int nb = 2 * DFF / 32, k0 = 64 * (r / nb), n0 = 32 * (r % nb);
            p0_transpose_item(INP(IN_WFI) + (size_t)l * DM * 2 * DFF, DM, 2 * DFF, (bf16*)(F.ws + (l ? WS_WFI1 : WS_WFI0)), k0, n0, gated_row(n0, DFF), scr, F.lane); continue; } r -= 2 * I_FI;
        if (r < 2 * I_FO) { const int l = r / I_FO; r -= l * I_FO; const int nb = 32, k0 = 64 * (r / nb), n0 = 32 * (r % nb);
            p0_transpose_item(INP(IN_WFO) + (size_t)l * DFF * DM, DFF, DM, (bf16*)(F.ws + (l ? WS_WFO1 : WS_WFO0)), k0, n0, n0, scr, F.lane); continue; } r -= 2 * I_FO;
        if (r < I_P1) { const int nb = 64, k0 = 64 * (r / nb), n0 = 32 * (r % nb); p0_transpose_item(INP(IN_WPW1), DM, 2 * DM, (bf16*)(F.ws + WS_WPW1), k0, n0, gated_row(n0, DM), scr, F.lane); continue; } r -= I_P1;
        { const int nb = 32, k0 = 64 * (r / nb), n0 = 32 * (r % nb); p0_transpose_item(INP(IN_WPW2), DM, DM, (bf16*)(F.ws + WS_WPW2), k0, n0, n0, scr, F.lane); }
    }
}
__device__ __forceinline__ void norm_mod_rows(Frame& F, const float* src, bf16* dst, int nrows, const float* gvec, int l, int c_sh, int c_sc, int fixed_mrow) {
    const int gw = F.vcu * NWAVES + F.wave, NGW = F.G * NWAVES;
    for (int ch = gw; ch < nrows / 16; ch += NGW) {
        const int r0 = ch * 16, mr = fixed_mrow >= 0 ? fixed_mrow : (r0 >> 12);
        const float* sc = modp(F, l, mr, c_sc); const float* sh = modp(F, l, mr, c_sh);
        f32x4 a[4], s[4];
#pragma unroll
        for (int j = 0; j < 4; ++j) { const int k = 4 * F.lane + 256 * j; const f32x4 g = *(const f32x4*)(gvec + k), c1 = *(const f32x4*)(sc + k); a[j] = g * (c1 + 1.0f); s[j] = *(const f32x4*)(sh + k); }
        for (int rr = 0; rr < 16; ++rr) {
            const f32x4* xr = (const f32x4*)(src + (size_t)(r0 + rr) * DM) + F.lane;
            f32x4 v[4]; float ss = 0.f;
#pragma unroll
            for (int j = 0; j < 4; ++j) { v[j] = xr[64 * j]; ss += (v[j].x * v[j].x + v[j].y * v[j].y) + (v[j].z * v[j].z + v[j].w * v[j].w); }
            const float rs = rsqrtf(wave_sum(ss) * (1.0f / DM) + EPS);
            unsigned long long* o8 = (unsigned long long*)(dst + (size_t)(r0 + rr) * DM) + F.lane;
#pragma unroll
            for (int j = 0; j < 4; ++j) { const f32x4 o = v[j] * rs * a[j] + s[j]; o8[64 * j] = (unsigned long long)pk2(o.x, o.y) | ((unsigned long long)pk2(o.z, o.w) << 32); }
        }
    }
}
__device__ __forceinline__ void final_norm_rows(Frame& F, float* io, int nrows, const float* gvec) {
    const int gw = F.vcu * NWAVES + F.wave, NGW = F.G * NWAVES;
    f32x4 a[4];
#pragma unroll
    for (int j = 0; j < 4; ++j) a[j] = *(const f32x4*)(gvec + 4 * F.lane + 256 * j);
    for (int ch = gw; ch < nrows / 16; ch += NGW)
        for (int rr = 0; rr < 16; ++rr) {
            f32x4* xr = (f32x4*)(io + (size_t)(ch * 16 + rr) * DM) + F.lane;
            f32x4 v[4]; float ss = 0.f;
#pragma unroll
            for (int j = 0; j < 4; ++j) { v[j] = xr[64 * j]; ss += (v[j].x * v[j].x + v[j].y * v[j].y) + (v[j].z * v[j].z + v[j].w * v[j].w); }
            const float rs = rsqrtf(wave_sum(ss) * (1.0f / DM) + EPS);
#pragma unroll
            for (int j = 0; j < 4; ++j) xr[64 * j] = v[j] * rs * a[j];
        }
}
__device__ __forceinline__ void ln_silu_rows(Frame& F, const float* src, bf16* dst, int nrows, const float* lng, const float* lnb) {
    const int gw = F.vcu * NWAVES + F.wave, NGW = F.G * NWAVES;
    f32x4 a[4], s[4];
#pragma unroll
    for (int j = 0; j < 4; ++j) { a[j] = *(const f32x4*)(lng + 4 * F.lane + 256 * j); s[j] = *(const f32x4*)(lnb + 4 * F.lane + 256 * j); }
    for (int ch = gw; ch < nrows / 16; ch += NGW)
        for (int rr = 0; rr < 16; ++rr) {
            const size_t row = (size_t)ch * 16 + rr;
            const f32x4* xr = (const f32x4*)(src + row * DM) + F.lane;
            f32x4 v[4]; float sm = 0.f;
#pragma unroll
            for (int j = 0; j < 4; ++j) { v[j] = xr[64 * j]; sm += (v[j].x + v[j].y) + (v[j].z + v[j].w); }
            const float mean = wave_sum(sm) * (1.0f / DM); float s2 = 0.f;
#pragma unroll
            for (int j = 0; j < 4; ++j) { v[j] = v[j] - mean; s2 += (v[j].x * v[j].x + v[j].y * v[j].y) + (v[j].z * v[j].z + v[j].w * v[j].w); }
            const float rs = rsqrtf(wave_sum(s2) * (1.0f / DM) + EPS);
            unsigned long long* o8 = (unsigned long long*)(dst + row * DM) + F.lane;
#pragma unroll
            for (int j = 0; j < 4; ++j) { const f32x4 y = v[j] * rs * a[j] + s[j]; o8[64 * j] = (unsigned long long)pk2(silu_f(y.x), silu_f(y.y)) | ((unsigned long long)pk2(silu_f(y.z), silu_f(y.w)) << 32); }
        }
}
__device__ __forceinline__ void unpack8(const v4u w, float (&x)[8]) { x[0] = bflo(w.x); x[1] = bfhi(w.x); x[2] = bflo(w.y); x[3] = bfhi(w.y); x[4] = bflo(w.z); x[5] = bfhi(w.z); x[6] = bflo(w.w); x[7] = bfhi(w.w); }
__device__ __forceinline__ v4u pack8(const float (&x)[8]) { v4u o; o.x = pk2(x[0], x[1]); o.y = pk2(x[2], x[3]); o.z = pk2(x[4], x[5]); o.w = pk2(x[6], x[7]); return o; }
__device__ __forceinline__ void head_norm_rope(float (&x)[8], const float* gain, const float* rope, int dc, int prow, int pcol, bool rot, float scale) {
    float ss = 0.f;
#pragma unroll
    for (int j = 0; j < 8; ++j) ss += x[j] * x[j];
    ss += __shfl_xor(ss, 1); ss += __shfl_xor(ss, 2); ss += __shfl_xor(ss, 4);
    const float rs = rsqrtf(ss * (1.0f / 64.0f) + EPS);
#pragma unroll
    for (int j = 0; j < 8; ++j) x[j] = x[j] * rs * gain[dc * 8 + j];
    float pv[8];
#pragma unroll
    for (int j = 0; j < 8; ++j) pv[j] = __shfl_xor(x[j], 2);
    if (rot) {
        const int pos = dc < 4 ? prow : pcol; const float* tab = rope + (pos * 16 + 8 * (dc & 1)) * 2;
#pragma unroll
        for (int j = 0; j < 8; ++j) { const float c = tab[2 * j], sn = tab[2 * j + 1]; x[j] = (dc & 2) ? x[j] * c + pv[j] * sn : x[j] * c - pv[j] * sn; }
    }
#pragma unroll
    for (int j = 0; j < 8; ++j) x[j] *= scale;
}
__device__ __forceinline__ void post_latent_row(Frame& F, int m) {
    const bf16* raw = (const bf16*)(F.ws + WS_RAW) + (size_t)m * INW; const int lane = F.lane, b = m >> 12, s = m & 4095, prow = s >> 6, pcol = s & 63, dc = lane & 7;
    const float* rope = (const float*)(F.ws + WS_ROPE);
    float x[8];
    unpack8(*(const v4u*)(raw + lane * 8), x);
    head_norm_rope(x, INP(IN_QG), rope, dc, prow, pcol, true, QSCALE);
    *(v4u*)((bf16*)(F.ws + WS_Q) + (size_t)m * AW + lane * 8) = pack8(x);
    { const int kl = lane & 15, kh = kl >> 3;
      unpack8(*(const v4u*)(raw + AW + kl * 8), x);
      head_norm_rope(x, INP(IN_KG), rope, dc, prow, pcol, true, 1.0f);
      const size_t krow = ((size_t)(b * NKVH + kh) * SKV + CTXL + s) * HD;
      if (lane < 16) { *(v4u*)((bf16*)(F.ws + WS_K) + krow + dc * 8) = pack8(x);
                       *(v4u*)((bf16*)(F.ws + WS_V) + krow + dc * 8) = *(const v4u*)(raw + AW + KVW + kl * 8); } }
    unpack8(*(const v4u*)(raw + AW + 2 * KVW + lane * 8), x);
#pragma unroll
    for (int j = 0; j < 8; ++j) x[j] = gelu_tanh(x[j]);
    *(v4u*)((bf16*)(F.ws + WS_U) + (size_t)m * SGW + lane * 8) = pack8(x);
    unpack8(*(const v4u*)(raw + AW + 2 * KVW + SGW + lane * 8), x);
    float sm = 0.f;
#pragma unroll
    for (int j = 0; j < 8; ++j) { x[j] = gelu_tanh(x[j]); sm += x[j]; }
    sm += __shfl_xor(sm, 1); sm += __shfl_xor(sm, 2); sm += __shfl_xor(sm, 4); sm += __shfl_xor(sm, 8);
    const float mean = sm * (1.0f / 128.0f); float s2 = 0.f;
#pragma unroll
    for (int j = 0; j < 8; ++j) { x[j] -= mean; s2 += x[j] * x[j]; }
    s2 += __shfl_xor(s2, 1); s2 += __shfl_xor(s2, 2); s2 += __shfl_xor(s2, 4); s2 += __shfl_xor(s2, 8);
    const float rs = rsqrtf(s2 * (1.0f / 128.0f) + EPS);
#pragma unroll
    for (int j = 0; j < 8; ++j) x[j] *= rs;
    *(v4u*)((bf16*)(F.ws + WS_VN) + (size_t)m * SGW + lane * 8) = pack8(x);
}
__device__ __forceinline__ void post_ctx_row(Frame& F, int mc) {
    const bf16* raw = (const bf16*)(F.ws + WS_RAW) + (size_t)(M + mc) * INW; const int lane = F.lane, b = mc >> 8, j0 = mc & 255, dc = lane & 7, kl = lane & 15, kh = kl >> 3;
    float x[8];
    unpack8(*(const v4u*)(raw + AW + kl * 8), x);
    head_norm_rope(x, INP(IN_KG), (const float*)(F.ws + WS_ROPE), dc, 0, 0, false, 1.0f);
    const size_t krow = ((size_t)(b * NKVH + kh) * SKV + j0) * HD;
    if (lane < 16) { *(v4u*)((bf16*)(F.ws + WS_K) + krow + dc * 8) = pack8(x);
                     *(v4u*)((bf16*)(F.ws + WS_V) + krow + dc * 8) = *(const v4u*)(raw + AW + KVW + kl * 8); }
}
__device__ __forceinline__ void sg_item(Frame& F, int item) {
    const int g = item & 3; const size_t row0 = (size_t)(item >> 2) * 128; const int lane = F.lane, w = F.wave;
    LAS bf16* VT = (LAS bf16*)F.lds;
    const bf16* VN = (const bf16*)(F.ws + WS_VN);
#pragma unroll
    for (int i = 0; i < 4; ++i) { const int ch = F.tid + i * 512, q = ch >> 4, cc = (ch & 15) * 8;
        const v4u val = *(const v4u*)(VN + (row0 + q) * SGW + g * 128 + cc);
        const unsigned wd[4] = {val.x, val.y, val.z, val.w};
#pragma unroll
        for (int j = 0; j < 4; ++j) { VT[(cc + 2 * j) * 136 + q] = (bf16)(wd[j] & 0xffffu); VT[(cc + 2 * j + 1) * 136 + q] = (bf16)(wd[j] >> 16); } }
    __syncthreads();
    const bf16* WSPB = (const bf16*)(F.ws + WS_WSP); const int p = 16 * w + (lane & 15);
    bf16x8 bw[4];
#pragma unroll
    for (int ks = 0; ks < 4; ++ks) bw[ks] = *(const bf16x8*)(WSPB + (size_t)(g * 128 + p) * 128 + 32 * ks + 8 * (lane >> 4));
    const float bias = INP(IN_BSP)[g * 128 + p];
    const bf16* U = (const bf16*)(F.ws + WS_U); bf16* CAT = (bf16*)(F.ws + WS_CAT);
#pragma unroll 2
    for (int cb = 0; cb < 8; ++cb) {
        f32x4 acc = {0.f, 0.f, 0.f, 0.f};
#pragma unroll
        for (int ks = 0; ks < 4; ++ks) { const bf16x8 a = *(const LAS bf16x8*)(VT + (16 * cb + (lane & 15)) * 136 + 32 * ks + 8 * (lane >> 4)); acc = __builtin_amdgcn_mfma_f32_16x16x32_bf16(a, bw[ks], acc, 0, 0, 0); }
        const int c0 = 16 * cb + 4 * (lane >> 4);
        const unsigned long long uu = *(const unsigned long long*)(U + (row0 + p) * SGW + g * 128 + c0);
        const unsigned ulo = (unsigned)uu, uhi = (unsigned)(uu >> 32);
        const float o0 = bflo(ulo) * (acc[0] + bias), o1 = bfhi(ulo) * (acc[1] + bias), o2 = bflo(uhi) * (acc[2] + bias), o3 = bfhi(uhi) * (acc[3] + bias);
        *(unsigned long long*)(CAT + (row0 + p) * DM + AW + g * 128 + c0) = (unsigned long long)pk2(o0, o1) | ((unsigned long long)pk2(o2, o3) << 32);
    }
    __syncthreads();
}
template <int R> __device__ __forceinline__ void conv_rows(f32x2 (&acc)[32], const f32x2 (&w)[31], const bf16* gp, int ta) {
    if constexpr (R < 62) {
        f32x2 x = {0.f, 0.f};
        if (ta >= 0 && ta < SEQ) { const unsigned u = *(const unsigned*)gp; x.x = bflo(u); x.y = bfhi(u); }
#pragma unroll
        for (int t = 0; t < 32; ++t) { if (R - t >= 0 && R - t <= 30) acc[t] += x * w[(R - t >= 0 && R - t <= 30) ? R - t : 0]; }
        gp += DM; asm volatile("" : "+v"(gp));
        conv_rows<R + 1>(acc, w, gp, ta + 1);
    }
}
__device__ __forceinline__ void conv_phase(Frame& F) {
    const int ch = 2 * F.tid;
    f32x2 w[31];
    { const float* wp = INP(IN_WDW) + ch;
#pragma unroll
      for (int j = 0; j < 31; ++j) { w[j] = *(const f32x2*)wp; wp += DM; asm volatile("" : "+v"(wp)); } }
    const f32x2 bd = *(const f32x2*)(INP(IN_BDW) + ch);
    for (int tile = F.vcu; tile < NB * 128; tile += F.G) {
        const int b = tile >> 7, t0 = (tile & 127) * 32;
        f32x2 acc[32];
#pragma unroll
        for (int t = 0; t < 32; ++t) acc[t] = bd;
        const bf16* gb = (const bf16*)(F.ws + WS_G) + (size_t)b * SEQ * DM + ch;
        conv_rows<0>(acc, w, gb + (ptrdiff_t)(t0 - 15) * DM, t0 - 15);
        float* co = (float*)(F.ws + WS_ACT) + ((size_t)b * SEQ + t0) * DM + ch;
#pragma unroll
        for (int t = 0; t < 32; ++t) { *(f32x2*)co = acc[t]; co += DM; asm volatile("" : "+v"(co)); }
    }
}
__global__ void __launch_bounds__(NWAVES * 64, 2) dit_fwd(Args args) {
    extern __shared__ __attribute__((aligned(16))) unsigned char lds[];
    Frame F;
    F.lds = (LAS unsigned char*)lds;
    F.MISC = (volatile LAS unsigned*)(F.lds + MISC_OFF);
    F.tid = threadIdx.x; F.lane = F.tid & 63; F.wave = __builtin_amdgcn_readfirstlane(F.tid >> 6);
    F.G = gridDim.x; { const int bx = blockIdx.x; F.vcu = (F.G % 8 == 0) ? (bx % 8) * (F.G / 8) + bx / 8 : bx; }
    F.out = args.out; F.ws = args.ws; F.ctl = (gu32*)(args.ws + WS_CTL);
    for (int u = F.tid; u < (LDS_BYTES - LDSCTL_OFF) / 4; u += NWAVES * 64) ((LAS unsigned*)(F.lds + LDSCTL_OFF))[u] = 0u;
    __syncthreads();
    XcdBarrier bar; bar.bar = (unsigned*)(F.ctl + CW_BAR); bar.x = 0; bar.st = nullptr;
    if (!MK_PER_PHASE) bar = xcd_barrier_post((unsigned*)(F.ctl + CW_BAR), F.MISC + 8);
    const int lo = args.ph_lo, hi = args.ph_hi;
#define IN(k) (lo <= (k) && (k) < hi)
#define FRESH() do { int t_ = threadIdx.x; asm volatile("" : "+v"(t_)); F.tid = t_; F.lane = t_ & 63; } while (0)
#define SEAM(k) do { if (!MK_PER_PHASE && IN(k) && IN((k) + 1)) xcd_barrier(bar); } while (0)
    bf16* const XM = (bf16*)(F.ws + WS_XM); bf16* const CAT = (bf16*)(F.ws + WS_CAT); bf16* const ACT = (bf16*)(F.ws + WS_ACT); bf16* const GB = (bf16*)(F.ws + WS_G);
    const int gw = F.vcu * NWAVES + F.wave, NGW = F.G * NWAVES;

    if (IN(0)) { FRESH(); p0_prologue(F); } SEAM(0);
    if (IN(1)) { FRESH(); norm_mod_rows(F, INP(IN_X), XM, M, INP(IN_GMIX), 0, 0, 1, -1); norm_mod_rows(F, INP(IN_CTX), XM + (size_t)M * DM, MC, INP(IN_GMIX), 0, 0, 1, 8); } SEAM(1);
    if (IN(2)) { FRESH(); pg8::Gemm g{XM, (const bf16*)(F.ws + WS_WIN), M, INW, DM}; pg8::ExtraOrder S; S.s.init(M, INW, F.G, (int)blockIdx.x); S.extra = MC / 256; S.extra_pn = 2;
        pg8::EpiStoreBf16 E{(bf16*)(F.ws + WS_RAW), INW};
        pg8::gemm_phase<pg8::EpiStoreBf16, pg8::ExtraOrder, true, true>(F.lds + RING_OFF, g, S, E); } SEAM(2);
    if (IN(3)) { FRESH(); for (int m = gw; m < M; m += NGW) post_latent_row(F, m); for (int m = gw; m < MC; m += NGW) post_ctx_row(F, m); } SEAM(3);
    if (IN(4)) { FRESH();
        const attn_body::AttnTensors AT{(const attn_body::bf16*)(F.ws + WS_Q), (const attn_body::bf16*)(F.ws + WS_K), (const attn_body::bf16*)(F.ws + WS_V), (attn_body::bf16*)(F.ws + WS_CAT)};
        const attn_body::StaticOrder S((int)F.G, (int)blockIdx.x);
        attn_body::attn_phase<attn_body::StaticOrder>((char*)lds + RING_OFF, AT, S);
        __syncthreads();
        for (int it = F.vcu; it < NB * 32 * 4; it += F.G) sg_item(F, it);
    } SEAM(4);
    if (IN(5)) { FRESH(); pg8::Gemm g{CAT, (const bf16*)(F.ws + WS_WOUT), M, DM, DM}; pg8::StaticOrder S; S.init(M, DM, F.G, (int)blockIdx.x);
        pg8::EpiRes E{INP(IN_X), F.out, DM, modp(F, 0, 0, 2), 9 * 0 + NMOD, nullptr, 12};
        pg8::gemm_phase<pg8::EpiRes, pg8::StaticOrder, true, true>(F.lds + RING_OFF, g, S, E); } SEAM(5);
    if (IN(6)) { FRESH(); norm_mod_rows(F, F.out, XM, M, INP(IN_GFFN), 0, 3, 4, -1); } SEAM(6);
    if (IN(7)) { FRESH(); pg8::Gemm g{XM, (const bf16*)(F.ws + WS_WFI0), M, 2 * DFF, DM}; pg8::StaticOrder S; S.init(M, 2 * DFF, F.G, (int)blockIdx.x);
        pg8::EpiSwiGLU E{ACT, DFF};
        pg8::gemm_phase<pg8::EpiSwiGLU, pg8::StaticOrder, true, true>(F.lds + RING_OFF, g, S, E); } SEAM(7);
    if (IN(8)) { FRESH(); pg8::Gemm g{ACT, (const bf16*)(F.ws + WS_WFO0), M, DM, DFF}; pg8::StaticOrder S; S.init(M, DM, F.G, (int)blockIdx.x);
        pg8::EpiRes E{F.out, F.out, DM, modp(F, 0, 0, 5), NMOD, nullptr, 12};
        pg8::gemm_phase<pg8::EpiRes, pg8::StaticOrder, true, true>(F.lds + RING_OFF, g, S, E); } SEAM(8);
    if (IN(9)) { FRESH(); norm_mod_rows(F, F.out, XM, M, INP(IN_GMIX) + DM, 1, 0, 1, -1); } SEAM(9);
    if (IN(10)) { FRESH(); pg8::Gemm g{XM, (const bf16*)(F.ws + WS_WPW1), M, 2 * DM, DM}; pg8::StaticOrder S; S.init(M, 2 * DM, F.G, (int)blockIdx.x);
        pg8::EpiGLU E{GB, DM, INP(IN_BPW1)};
        pg8::gemm_phase<pg8::EpiGLU, pg8::StaticOrder, true, true>(F.lds + RING_OFF, g, S, E); } SEAM(10);
    if (IN(11)) { FRESH(); conv_phase(F); } SEAM(11);
    if (IN(12)) { FRESH(); ln_silu_rows(F, (const float*)(F.ws + WS_ACT), XM, M, INP(IN_LNG), INP(IN_LNB)); } SEAM(12);
    if (IN(13)) { FRESH(); pg8::Gemm g{XM, (const bf16*)(F.ws + WS_WPW2), M, DM, DM}; pg8::StaticOrder S; S.init(M, DM, F.G, (int)blockIdx.x);
        pg8::EpiRes E{F.out, F.out, DM, modp(F, 1, 0, 2), NMOD, INP(IN_BPW2), 12};
        pg8::gemm_phase<pg8::EpiRes, pg8::StaticOrder, true, true>(F.lds + RING_OFF, g, S, E); } SEAM(13);
    if (IN(14)) { FRESH(); norm_mod_rows(F, F.out, XM, M, INP(IN_GFFN) + DM, 1, 3, 4, -1); } SEAM(14);
    if (IN(15)) { FRESH(); pg8::Gemm g{XM, (const bf16*)(F.ws + WS_WFI1), M, 2 * DFF, DM}; pg8::StaticOrder S; S.init(M, 2 * DFF, F.G, (int)blockIdx.x);
        pg8::EpiSwiGLU E{ACT, DFF};
        pg8::gemm_phase<pg8::EpiSwiGLU, pg8::StaticOrder, true, true>(F.lds + RING_OFF, g, S, E); } SEAM(15);
    if (IN(16)) { FRESH(); pg8::Gemm g{ACT, (const bf16*)(F.ws + WS_WFO1), M, DM, DFF}; pg8::StaticOrder S; S.init(M, DM, F.G, (int)blockIdx.x);
        pg8::EpiRes E{F.out, F.out, DM, modp(F, 1, 0, 5), NMOD, nullptr, 12};
        pg8::gemm_phase<pg8::EpiRes, pg8::StaticOrder, true, true>(F.lds + RING_OFF, g, S, E); } SEAM(16);
    if (IN(17)) { FRESH(); final_norm_rows(F, F.out, M, INP(IN_GFIN)); }
#undef IN
#undef SEAM
}

extern "C" void kernel_launch(void* const* d_in, const int* in_sizes, int n_in, void* d_out, int out_size, void* d_ws, size_t ws_size, hipStream_t stream) {
    static int grid = 0;
    if (grid == 0) {
        if (n_in != 25 || in_sizes[0] != M * DM || out_size != M * DM || ws_size < WS_END) { fprintf(stderr, "kernel_launch: unexpected shapes (n_in %d, in0 %d, out %d, ws %zu); nothing launched\n", n_in, n_in > 0 ? in_sizes[0] : -1, out_size, ws_size); grid = -1; return; }
        int dev = 0, cus = 0, per_cu = 0;
        if (hipGetDevice(&dev) != hipSuccess || hipDeviceGetAttribute(&cus, hipDeviceAttributeMultiprocessorCount, dev) != hipSuccess) { fprintf(stderr, "kernel_launch: device query failed\n"); grid = -1; return; }
        if (hipFuncSetAttribute((const void*)dit_fwd, hipFuncAttributeMaxDynamicSharedMemorySize, LDS_BYTES) != hipSuccess) { fprintf(stderr, "kernel_launch: hipFuncSetAttribute failed\n"); grid = -1; return; }
        if (hipOccupancyMaxActiveBlocksPerMultiprocessor(&per_cu, (const void*)dit_fwd, NWAVES * 64, LDS_BYTES) != hipSuccess || per_cu < 1) fprintf(stderr, "kernel_launch: note: occupancy query reports %d workgroups per CU\n", per_cu);
        (void)hipGetLastError();
        grid = cus;
        if (grid % 8 != 0 || grid > 256) grid = (grid > 256) ? 256 : (grid / 8) * 8;
    }
    if (grid <= 0) return;
    if (hipMemsetAsync((char*)d_ws + WS_CTL, 0, CTL_ZERO_BYTES, stream) != hipSuccess) { fprintf(stderr, "kernel_launch: hipMemsetAsync failed\n"); return; }
    Args a{};
    for (int i = 0; i < 25; ++i) a.in[i] = (const float*)d_in[i];
    a.out = (float*)d_out; a.ws = (unsigned char*)d_ws;
#if MK_PER_PHASE
    for (int p = 0; p < N_PHASES; ++p) { a.ph_lo = p; a.ph_hi = p + 1; hipLaunchKernelGGL(dit_fwd, dim3(grid), dim3(NWAVES * 64), LDS_BYTES, stream, a); }
#else
    a.ph_lo = 0; a.ph_hi = N_PHASES;
    hipLaunchKernelGGL(dit_fwd, dim3(grid), dim3(NWAVES * 64), LDS_BYTES, stream, a);
#endif
    const hipError_t le = hipPeekAtLastError();
    if (le != hipSuccess) fprintf(stderr, "kernel_launch: launch failed: %s\n", hipGetErrorName(le));
}
```
